# Optimizing an MI355X kernel written in HIP

```python
import jax, jax.numpy as jnp
from jax import lax
import numpy as np

D_MODEL = 1024
BATCH = 2
SEQ = 8192
DEPTH = 2

CHUNK = 64
N_MIXERS = 2
CONV_WIDTH = 3
N_HEADS = 16
HEAD_DIM = D_MODEL // N_HEADS
LEFT_CHUNKS = 8
BAND = (LEFT_CHUNKS + 1) * CHUNK
MAX_REL_DIST = 256
N_REL = 2 * MAX_REL_DIST + 1
D_FF = (((8 * D_MODEL + 2) // 3 + 255) // 256) * 256
N_CONV_LAYERS = (DEPTH + N_MIXERS - 1) // N_MIXERS
N_ATTN_LAYERS = DEPTH // N_MIXERS
N_ADA = 6
RMS_EPS = 1e-6
NEG_INF = -1e30

kernel_name = "hybrid_conv_chunkattn_sandwich_adaln"


def rms_norm(x, g):
    xf = x.astype(jnp.float32)
    y = xf * lax.rsqrt(jnp.mean(xf * xf, axis=-1, keepdims=True) + RMS_EPS)
    return (y * g.astype(jnp.float32)).astype(x.dtype)


def modulate(h, shift, scale):
    return h * (1.0 + scale[:, None, :]) + shift[:, None, :]


def short_conv_mixer(h, w_in, w_conv, w_out):
    d = h.shape[-1]
    bcv = h @ w_in
    gate_b, gate_c, v = jnp.split(bcv, 3, axis=-1)
    u = gate_c * v
    conv = lax.conv_general_dilated(
        u, w_conv[:, None, :].astype(u.dtype),
        window_strides=(1,), padding=[(CONV_WIDTH - 1, 0)],
        dimension_numbers=("NWC", "WIO", "NWC"), feature_group_count=d)
    return (gate_b * conv) @ w_out


def _rel_bias_index():
    qi = np.arange(CHUNK)[:, None]
    kj = np.arange(BAND)[None, :]
    dist = qi + LEFT_CHUNKS * CHUNK - kj
    return (np.clip(dist, -MAX_REL_DIST, MAX_REL_DIST) + MAX_REL_DIST).astype(np.int32)


def chunked_rel_attention(h, w_qkv, rel_bias, w_out):
    b, s, d = h.shape
    n_chunks = s // CHUNK
    qkv = (h @ w_qkv).reshape(b, s, 3, N_HEADS, HEAD_DIM)
    q = qkv[:, :, 0] * (HEAD_DIM ** -0.5)
    k = qkv[:, :, 1]
    v = qkv[:, :, 2]
    pad = ((0, 0), (LEFT_CHUNKS * CHUNK, 0), (0, 0), (0, 0))
    k_pad = jnp.pad(k, pad)
    v_pad = jnp.pad(v, pad)
    q_chunks = q.reshape(b, n_chunks, CHUNK, N_HEADS, HEAD_DIM).transpose(1, 0, 2, 3, 4)
    bias = rel_bias.astype(jnp.float32)[:, jnp.asarray(_rel_bias_index())]
    key_slot = jnp.arange(BAND)

    def one_chunk(args):
        n, qc = args
        kb = lax.dynamic_slice_in_dim(k_pad, n * CHUNK, BAND, axis=1)
        vb = lax.dynamic_slice_in_dim(v_pad, n * CHUNK, BAND, axis=1)
        scores = jnp.einsum("bqhd,bkhd->bhqk", qc, kb).astype(jnp.float32) + bias[None]
        valid = key_slot >= (LEFT_CHUNKS - n) * CHUNK
        scores = jnp.where(valid[None, None, None, :], scores, NEG_INF)
        p = jax.nn.softmax(scores, axis=-1).astype(vb.dtype)
        return jnp.einsum("bhqk,bkhd->bqhd", p, vb)

    out = lax.map(one_chunk, (jnp.arange(n_chunks, dtype=jnp.int32), q_chunks))
    out = out.transpose(1, 0, 2, 3, 4).reshape(b, s, d)
    return out @ w_out


def swiglu(h, w_gate_up, w_down):
    g, u = jnp.split(h @ w_gate_up, 2, axis=-1)
    return (jax.nn.silu(g) * u) @ w_down


def setup_inputs(seed: int = 0) -> dict:
    key = jax.random.key(seed)
    ks = jax.random.split(key, 14)
    f32 = jnp.float32
    sd = D_MODEL ** -0.5
    x = jax.random.normal(ks[0], (BATCH, SEQ, D_MODEL), f32)
    c = jax.random.normal(ks[1], (BATCH, D_MODEL), f32)
    ada_w = jax.random.normal(ks[2], (DEPTH, D_MODEL, N_ADA * D_MODEL), f32) * (0.5 * sd)
    ada_b = jax.random.normal(ks[3], (DEPTH, N_ADA * D_MODEL), f32) * 0.02
    norm_gains = 1.0 + 0.02 * jax.random.normal(ks[4], (DEPTH, 4, D_MODEL), f32)
    conv_w_in = jax.random.normal(ks[5], (N_CONV_LAYERS, D_MODEL, 3 * D_MODEL), f32) * sd
    conv_w = jax.random.normal(ks[6], (N_CONV_LAYERS, CONV_WIDTH, D_MODEL), f32) * (CONV_WIDTH ** -0.5)
    conv_w_out = jax.random.normal(ks[7], (N_CONV_LAYERS, D_MODEL, D_MODEL), f32) * sd
    attn_w_qkv = jax.random.normal(ks[8], (N_ATTN_LAYERS, D_MODEL, 3 * D_MODEL), f32) * sd
    attn_rel_bias = jax.random.normal(ks[9], (N_ATTN_LAYERS, N_HEADS, N_REL), f32) * 0.1
    attn_w_out = jax.random.normal(ks[10], (N_ATTN_LAYERS, D_MODEL, D_MODEL), f32) * sd
    ffn_w_gate_up = jax.random.normal(ks[11], (DEPTH, D_MODEL, 2 * D_FF), f32) * sd
    ffn_w_down = jax.random.normal(ks[12], (DEPTH, D_FF, D_MODEL), f32) * (D_FF ** -0.5)
    return {"x": x, "c": c, "ada_w": ada_w, "ada_b": ada_b, "norm_gains": norm_gains,
            "conv_w_in": conv_w_in, "conv_w": conv_w, "conv_w_out": conv_w_out,
            "attn_w_qkv": attn_w_qkv, "attn_rel_bias": attn_rel_bias, "attn_w_out": attn_w_out,
            "ffn_w_gate_up": ffn_w_gate_up, "ffn_w_down": ffn_w_down}


def reference(x, c, ada_w, ada_b, norm_gains, conv_w_in, conv_w, conv_w_out,
              attn_w_qkv, attn_rel_bias, attn_w_out, ffn_w_gate_up, ffn_w_down):
    c_act = jax.nn.silu(c)
    for i in range(DEPTH):
        mod = c_act @ ada_w[i] + ada_b[i]
        sh_m, sc_m, g_m, sh_f, sc_f, g_f = jnp.split(mod, N_ADA, axis=-1)
        h = modulate(rms_norm(x, norm_gains[i, 0]), sh_m, sc_m)
        j = i // N_MIXERS
        if i % N_MIXERS == 0:
            h = short_conv_mixer(h, conv_w_in[j], conv_w[j], conv_w_out[j])
        else:
            h = chunked_rel_attention(h, attn_w_qkv[j], attn_rel_bias[j], attn_w_out[j])
        x = x + g_m[:, None, :] * rms_norm(h, norm_gains[i, 1])
        h = modulate(rms_norm(x, norm_gains[i, 2]), sh_f, sc_f)
        h = swiglu(h, ffn_w_gate_up[i], ffn_w_down[i])
        x = x + g_f[:, None, :] * rms_norm(h, norm_gains[i, 3])
    return x
```

```cpp
#include <hip/hip_runtime.h>
#include <cstdint>
#include <cstdio>

constexpr int BATCH = 2, SEQ = 8192, D = 1024, NH = 16, HD = 64, FF = 2816, M = BATCH * SEQ;
constexpr int CHUNK = 64, LEFTC = 8, BAND = 576, MAXREL = 256, NREL = 513, NCHUNK = SEQ / CHUNK;
constexpr float RMS_EPS = 1e-6f;
constexpr float LOG2E = 1.4426950408889634f;
constexpr float QSCALE = 0.125f * LOG2E;

typedef unsigned short bf16;
typedef short bf16x8 __attribute__((ext_vector_type(8)));
typedef float f32x4 __attribute__((ext_vector_type(4)));
typedef float f32x16 __attribute__((ext_vector_type(16)));
typedef unsigned u32x4 __attribute__((ext_vector_type(4)));

constexpr size_t MiB = 1u << 20;
constexpr size_t WS_CTL = 0;
constexpr size_t WS_VEC = 1 * MiB;
constexpr size_t WS_WIN = 2 * MiB;
constexpr size_t WS_WCO = 8 * MiB;
constexpr size_t WS_WQKV = 10 * MiB;
constexpr size_t WS_WAO = 16 * MiB;
constexpr size_t WS_WGU = 18 * MiB;
constexpr size_t WS_WDN = 40 * MiB;
constexpr size_t WS_XCH = 52 * MiB;
constexpr size_t WS_XN = 56 * MiB;
constexpr size_t WS_BIG = 88 * MiB;
constexpr size_t WS_Y = 184 * MiB;
constexpr size_t WS_END = 256 * MiB;
enum { V_AM = 0, V_SM = 1, V_GM = 2, V_AF = 3, V_SF = 4, V_GF = 5 };

__device__ __forceinline__ unsigned f2bf(float f) { unsigned u = __builtin_bit_cast(unsigned, f); return (u + 0x7fffu + ((u >> 16) & 1u)) >> 16; }
__device__ __forceinline__ float bf2f(unsigned short h) { return __builtin_bit_cast(float, (unsigned)h << 16); }
__device__ __forceinline__ unsigned pk2(float lo, float hi) { return f2bf(lo) | (f2bf(hi) << 16); }
__device__ __forceinline__ float wave_sum(float v) {
#pragma unroll
    for (int o = 1; o < 64; o <<= 1) v += __shfl_xor(v, o);
    return v;
}
__device__ __forceinline__ float silu_f(float v) { return v / (1.f + __expf(-v)); }

__global__ void __launch_bounds__(256) s_mod(const float* __restrict__ c, const float* __restrict__ ada_w, const float* __restrict__ ada_b, const float* __restrict__ gains, float* __restrict__ vec) {
    __shared__ float ca[2][D];
    for (int i = threadIdx.x; i < 2 * D; i += 256) ca[i / D][i % D] = silu_f(c[i]);
    __syncthreads();
    const int gid = blockIdx.x * 256 + threadIdx.x;
    const int layer = gid / (6 * D), n = gid % (6 * D);
    const float* w = ada_w + (size_t)layer * D * 6 * D + n;
    float a0 = 0.f, a1 = 0.f;
    for (int k = 0; k < D; ++k) { const float wv = w[(size_t)k * 6 * D]; a0 += ca[0][k] * wv; a1 += ca[1][k] * wv; }
    const float bb = ada_b[layer * 6 * D + n]; a0 += bb; a1 += bb;
    const int j = n / D, col = n % D;
    const float* g = gains + (size_t)layer * 4 * D;
    int slot; float v0, v1;
    switch (j) {
        case 0: slot = V_SM; v0 = a0; v1 = a1; break;
        case 1: slot = V_AM; v0 = g[0 * D + col] * (1.f + a0); v1 = g[0 * D + col] * (1.f + a1); break;
        case 2: slot = V_GM; v0 = g[1 * D + col] * a0; v1 = g[1 * D + col] * a1; break;
        case 3: slot = V_SF; v0 = a0; v1 = a1; break;
        case 4: slot = V_AF; v0 = g[2 * D + col] * (1.f + a0); v1 = g[2 * D + col] * (1.f + a1); break;
        default: slot = V_GF; v0 = g[3 * D + col] * a0; v1 = g[3 * D + col] * a1; break;
    }
    vec[((size_t)(layer * 2 + 0) * 6 + slot) * D + col] = v0;
    vec[((size_t)(layer * 2 + 1) * 6 + slot) * D + col] = v1;
}

template <bool GU> __global__ void __launch_bounds__(256) s_wconv(const float* __restrict__ W, int K, int N, bf16* __restrict__ WT) {
    __shared__ float tile[32][33];
    const int tx = threadIdx.x & 31, ty = threadIdx.x >> 5;
    const int n0 = blockIdx.x * 32, k0 = blockIdx.y * 32;
    int c0 = n0;
    if (GU) { const int j = n0 >> 8, s = (n0 >> 7) & 1, r = n0 & 127; c0 = s * FF + 128 * j + r; }
#pragma unroll
    for (int i = 0; i < 4; ++i) tile[ty + 8 * i][tx] = W[(size_t)(k0 + ty + 8 * i) * N + c0 + tx];
    __syncthreads();
#pragma unroll
    for (int i = 0; i < 4; ++i) WT[(size_t)(n0 + ty + 8 * i) * K + k0 + tx] = (bf16)f2bf(tile[tx][ty + 8 * i]);
}

__global__ void __launch_bounds__(256) s_rmsmod(const float* __restrict__ x, const float* __restrict__ vecs  , int slotA, int slotS, bf16* __restrict__ xn) {
    const int lane = threadIdx.x & 63, row = blockIdx.x * 4 + (threadIdx.x >> 6);
    const int b = row / SEQ;
    const f32x4* xr = (const f32x4*)(x + (size_t)row * D) + lane;
    const f32x4* A = (const f32x4*)(vecs + ((size_t)b * 6 + slotA) * D) + lane;
    const f32x4* S = (const f32x4*)(vecs + ((size_t)b * 6 + slotS) * D) + lane;
    f32x4 v[4]; float ss = 0.f;
#pragma unroll
    for (int j = 0; j < 4; ++j) { v[j] = xr[64 * j]; ss += (v[j].x * v[j].x + v[j].y * v[j].y) + (v[j].z * v[j].z + v[j].w * v[j].w); }
    const float rstd = 1.f / sqrtf(wave_sum(ss) * (1.f / D) + RMS_EPS);
    unsigned long long* o8 = (unsigned long long*)(xn + (size_t)row * D) + lane;
#pragma unroll
    for (int j = 0; j < 4; ++j) { const f32x4 a = A[64 * j], s = S[64 * j]; const f32x4 r = v[j] * rstd * a + s;
        o8[64 * j] = (unsigned long long)pk2(r.x, r.y) | ((unsigned long long)pk2(r.z, r.w) << 32); }
}

template <int MODE> __global__ void __launch_bounds__(256) s_gemm(const bf16* __restrict__ A, const bf16* __restrict__ Bt, int K, void* __restrict__ Cout, int ldc, int split, size_t split_stride, float scale0) {
    const int lane = threadIdx.x & 63, wid = threadIdx.x >> 6, r = lane & 31, h = lane >> 5;
    const int m0 = blockIdx.y * 128 + wid * 32;
    int n0, n1;
    if (MODE == 1) { const int t = blockIdx.x >> 2, q = blockIdx.x & 3; n0 = t * 256 + q * 32; n1 = n0 + 128; }
    else { n0 = blockIdx.x * 64; n1 = n0 + 32; }
    const bf16* ap = A + (size_t)(m0 + r) * K + 8 * h;
    const bf16* b0p = Bt + (size_t)(n0 + r) * K + 8 * h;
    const bf16* b1p = Bt + (size_t)(n1 + r) * K + 8 * h;
    f32x16 acc0 = {}, acc1 = {};
    for (int k0 = 0; k0 < K; k0 += 16) {
        const bf16x8 a = *(const bf16x8*)(ap + k0), b0 = *(const bf16x8*)(b0p + k0), b1 = *(const bf16x8*)(b1p + k0);
        acc0 = __builtin_amdgcn_mfma_f32_32x32x16_bf16(a, b0, acc0, 0, 0, 0);
        acc1 = __builtin_amdgcn_mfma_f32_32x32x16_bf16(a, b1, acc1, 0, 0, 0);
    }
#pragma unroll
    for (int i = 0; i < 16; ++i) {
        const int row = m0 + (i & 3) + 8 * (i >> 2) + 4 * h;
        if (MODE == 0) {
            bf16* O = (bf16*)Cout;
            int c0 = n0 + r, c1 = n1 + r; float s0 = 1.f, s1 = 1.f;
            if (split) { const int t0 = c0 / D, t1 = c1 / D; if (t0 == 0) s0 = scale0; if (t1 == 0) s1 = scale0;
                O[(size_t)t0 * split_stride + (size_t)row * D + (c0 - t0 * D)] = (bf16)f2bf(acc0[i] * s0);
                O[(size_t)t1 * split_stride + (size_t)row * D + (c1 - t1 * D)] = (bf16)f2bf(acc1[i] * s1); }
            else { O[(size_t)row * ldc + c0] = (bf16)f2bf(acc0[i]); O[(size_t)row * ldc + c1] = (bf16)f2bf(acc1[i]); }
        } else if (MODE == 1) {
            bf16* O = (bf16*)Cout;
            const int ch = (n0 >> 8) * 128 + (n0 & 127) + r;
            O[(size_t)row * ldc + ch] = (bf16)f2bf(silu_f(acc0[i]) * acc1[i]);
        } else {
            float* O = (float*)Cout;
            O[(size_t)row * ldc + n0 + r] = acc0[i]; O[(size_t)row * ldc + n1 + r] = acc1[i];
        }
    }
}

__global__ void __launch_bounds__(256) s_convgate(const bf16* __restrict__ bcv, const float* __restrict__ cw  , bf16* __restrict__ y) {
    const size_t gid = (size_t)blockIdx.x * 256 + threadIdx.x;
    const int m = (int)(gid / D), ch = (int)(gid % D), t = m % SEQ;
    const bf16* p = bcv + (size_t)m * 3 * D + ch;
    float acc = 0.f;
#pragma unroll
    for (int k = 0; k < 3; ++k) { const int dt = 2 - k; if (t - dt >= 0) { const bf16* q = p - (size_t)dt * 3 * D; acc += cw[k * D + ch] * (bf2f(q[D]) * bf2f(q[2 * D])); } }
    y[(size_t)m * D + ch] = (bf16)f2bf(bf2f(p[0]) * acc);
}

template <bool FINAL> __global__ void __launch_bounds__(256) s_resnorm(const float* __restrict__ tmp, const float* base, float* out, const float* __restrict__ vecs, int slotG, const float* __restrict__ vecs_next, int slotA, int slotS, bf16* __restrict__ xn) {
    const int lane = threadIdx.x & 63, row = blockIdx.x * 4 + (threadIdx.x >> 6);
    const int b = row / SEQ;
    const f32x4* tr = (const f32x4*)(tmp + (size_t)row * D) + lane;
    const f32x4* br = (const f32x4*)(base + (size_t)row * D) + lane;
    const f32x4* G = (const f32x4*)(vecs + ((size_t)b * 6 + slotG) * D) + lane;
    f32x4 v[4]; float ss = 0.f;
#pragma unroll
    for (int j = 0; j < 4; ++j) { v[j] = tr[64 * j]; ss += (v[j].x * v[j].x + v[j].y * v[j].y) + (v[j].z * v[j].z + v[j].w * v[j].w); }
    const float rstd = 1.f / sqrtf(wave_sum(ss) * (1.f / D) + RMS_EPS);
    float s2 = 0.f;
#pragma unroll
    for (int j = 0; j < 4; ++j) { v[j] = br[64 * j] + G[64 * j] * (v[j] * rstd); s2 += (v[j].x * v[j].x + v[j].y * v[j].y) + (v[j].z * v[j].z + v[j].w * v[j].w); }
    f32x4* orow = (f32x4*)(out + (size_t)row * D) + lane;
#pragma unroll
    for (int j = 0; j < 4; ++j) orow[64 * j] = v[j];
    if (!FINAL) {
        const float rstd2 = 1.f / sqrtf(wave_sum(s2) * (1.f / D) + RMS_EPS);
        const f32x4* A = (const f32x4*)(vecs_next + ((size_t)b * 6 + slotA) * D) + lane;
        const f32x4* S = (const f32x4*)(vecs_next + ((size_t)b * 6 + slotS) * D) + lane;
        unsigned long long* o8 = (unsigned long long*)(xn + (size_t)row * D) + lane;
#pragma unroll
        for (int j = 0; j < 4; ++j) { const f32x4 r = v[j] * rstd2 * A[64 * j] + S[64 * j];
            o8[64 * j] = (unsigned long long)pk2(r.x, r.y) | ((unsigned long long)pk2(r.z, r.w) << 32); }
    }
}

__global__ void __launch_bounds__(64) s_attn(const bf16* Q, const bf16* __restrict__ Kb, const bf16* __restrict__ Vb, const float* __restrict__ relb  , bf16* O) {
    __shared__ float bias[NREL];
    const int n = blockIdx.x % NCHUNK, h = (blockIdx.x / NCHUNK) % NH, b = blockIdx.x / (NCHUNK * NH), i = threadIdx.x;
    for (int j = i; j < NREL; j += 64) bias[j] = relb[h * NREL + j] * LOG2E;
    __syncthreads();
    const size_t qrow = (size_t)b * SEQ + (size_t)n * CHUNK + i;
    float q[HD];
    { const bf16x8* qp = (const bf16x8*)(Q + qrow * D + h * HD);
#pragma unroll
      for (int c = 0; c < 8; ++c) { const bf16x8 v = qp[c];
#pragma unroll
          for (int e = 0; e < 8; ++e) q[c * 8 + e] = bf2f((unsigned short)v[e]); } }
    const int j0 = (n < LEFTC) ? (LEFTC - n) * CHUNK : 0;
    const bf16* kbase = Kb + ((long long)b * SEQ + (long long)n * CHUNK - LEFTC * CHUNK) * D + h * HD;
    const bf16* vbase = Vb + ((long long)b * SEQ + (long long)n * CHUNK - LEFTC * CHUNK) * D + h * HD;
    float mx = -3.0e38f;
    for (int j = j0; j < BAND; ++j) {
        const bf16x8* kp = (const bf16x8*)(kbase + (size_t)j * D);
        float s = 0.f;
#pragma unroll
        for (int c = 0; c < 8; ++c) { const bf16x8 v = kp[c];
#pragma unroll
            for (int e = 0; e < 8; ++e) s += q[c * 8 + e] * bf2f((unsigned short)v[e]); }
        int dist = i + LEFTC * CHUNK - j; dist = dist < -MAXREL ? -MAXREL : (dist > MAXREL ? MAXREL : dist);
        s += bias[dist + MAXREL];
        mx = fmaxf(mx, s);
    }
    float o[HD];
#pragma unroll
    for (int d = 0; d < HD; ++d) o[d] = 0.f;
    float l = 0.f;
    for (int j = j0; j < BAND; ++j) {
        const bf16x8* kp = (const bf16x8*)(kbase + (size_t)j * D);
        float s = 0.f;
#pragma unroll
        for (int c = 0; c < 8; ++c) { const bf16x8 v = kp[c];
#pragma unroll
            for (int e = 0; e < 8; ++e) s += q[c * 8 + e] * bf2f((unsigned short)v[e]); }
        int dist = i + LEFTC * CHUNK - j; dist = dist < -MAXREL ? -MAXREL : (dist > MAXREL ? MAXREL : dist);
        s += bias[dist + MAXREL];
        const float p = exp2f(s - mx);
        l += p;
        const bf16x8* vp = (const bf16x8*)(vbase + (size_t)j * D);
#pragma unroll
        for (int c = 0; c < 8; ++c) { const bf16x8 v = vp[c];
#pragma unroll
            for (int e = 0; e < 8; ++e) o[c * 8 + e] += p * bf2f((unsigned short)v[e]); }
    }
    const float rl = 1.f / l;
    u32x4* op = (u32x4*)(O + qrow * D + h * HD);
#pragma unroll
    for (int c = 0; c < 8; ++c) { u32x4 w; w.x = pk2(o[c * 8 + 0] * rl, o[c * 8 + 1] * rl); w.y = pk2(o[c * 8 + 2] * rl, o[c * 8 + 3] * rl); w.z = pk2(o[c * 8 + 4] * rl, o[c * 8 + 5] * rl); w.w = pk2(o[c * 8 + 6] * rl, o[c * 8 + 7] * rl); op[c] = w; }
}

extern "C" void kernel_launch(void* const* d_in, const int* in_sizes, int n_in, void* d_out, int out_size, void* d_ws, size_t ws_size, hipStream_t stream) {
    if (n_in != 13 || in_sizes[0] != M * D || out_size != M * D || ws_size < WS_END) { fprintf(stderr, "kernel_launch: unexpected shapes (n_in %d, in0 %d, out %d, ws %zu)\n", n_in, n_in > 0 ? in_sizes[0] : -1, out_size, ws_size); return; }
    const float* x = (const float*)d_in[0]; const float* c = (const float*)d_in[1]; const float* ada_w = (const float*)d_in[2]; const float* ada_b = (const float*)d_in[3];
    const float* gains = (const float*)d_in[4]; const float* conv_w_in = (const float*)d_in[5]; const float* conv_w = (const float*)d_in[6]; const float* conv_w_out = (const float*)d_in[7];
    const float* attn_w_qkv = (const float*)d_in[8]; const float* relb = (const float*)d_in[9]; const float* attn_w_out = (const float*)d_in[10];
    const float* w_gu = (const float*)d_in[11]; const float* w_dn = (const float*)d_in[12];
    float* out = (float*)d_out; unsigned char* ws = (unsigned char*)d_ws;
    float* vec = (float*)(ws + WS_VEC);
    bf16 *Win = (bf16*)(ws + WS_WIN), *Wco = (bf16*)(ws + WS_WCO), *Wqkv = (bf16*)(ws + WS_WQKV), *Wao = (bf16*)(ws + WS_WAO), *Wgu = (bf16*)(ws + WS_WGU), *Wdn = (bf16*)(ws + WS_WDN);
    bf16 *XN = (bf16*)(ws + WS_XN), *BIG = (bf16*)(ws + WS_BIG), *Y = (bf16*)(ws + WS_Y);
    const size_t MD = (size_t)M * D;

    s_mod<<<2 * 6 * D / 256, 256, 0, stream>>>(c, ada_w, ada_b, gains, vec);
    s_wconv<false><<<dim3(3 * D / 32, D / 32), 256, 0, stream>>>(conv_w_in, D, 3 * D, Win);
    s_wconv<false><<<dim3(D / 32, D / 32), 256, 0, stream>>>(conv_w_out, D, D, Wco);
    s_wconv<false><<<dim3(3 * D / 32, D / 32), 256, 0, stream>>>(attn_w_qkv, D, 3 * D, Wqkv);
    s_wconv<false><<<dim3(D / 32, D / 32), 256, 0, stream>>>(attn_w_out, D, D, Wao);
    for (int l = 0; l < 2; ++l) {
        s_wconv<true><<<dim3(2 * FF / 32, D / 32), 256, 0, stream>>>(w_gu + (size_t)l * D * 2 * FF, D, 2 * FF, Wgu + (size_t)l * 2 * FF * D);
        s_wconv<false><<<dim3(D / 32, FF / 32), 256, 0, stream>>>(w_dn + (size_t)l * FF * D, FF, D, Wdn + (size_t)l * D * FF);
    }
    const float* vec0 = vec; const float* vec1 = vec + 2 * 6 * D;
    s_rmsmod<<<M / 4, 256, 0, stream>>>(x, vec0, V_AM, V_SM, XN);
    s_gemm<0><<<dim3(3 * D / 64, M / 128), 256, 0, stream>>>(XN, Win, D, BIG, 3 * D, 0, 0, 1.f);
    s_convgate<<<(unsigned)(MD / 256), 256, 0, stream>>>(BIG, conv_w, Y);
    float* TMP = (float*)(ws + WS_BIG);
    s_gemm<2><<<dim3(D / 64, M / 128), 256, 0, stream>>>(Y, Wco, D, TMP, D, 0, 0, 1.f);
    s_resnorm<false><<<M / 4, 256, 0, stream>>>(TMP, x, out, vec0, V_GM, vec0, V_AF, V_SF, XN);
    s_gemm<1><<<dim3(2 * FF / 64, M / 128), 256, 0, stream>>>(XN, Wgu, D, BIG, FF, 0, 0, 1.f);
    float* TMP2 = (float*)(ws + WS_BIG + 88 * MiB);
    s_gemm<2><<<dim3(D / 64, M / 128), 256, 0, stream>>>(BIG, Wdn, FF, TMP2, D, 0, 0, 1.f);
    s_resnorm<false><<<M / 4, 256, 0, stream>>>(TMP2, out, out, vec0, V_GF, vec1, V_AM, V_SM, XN);
    s_gemm<0><<<dim3(3 * D / 64, M / 128), 256, 0, stream>>>(XN, Wqkv, D, BIG, D, 1, MD, QSCALE);
    s_attn<<<BATCH * NH * NCHUNK, 64, 0, stream>>>(BIG, BIG + MD, BIG + 2 * MD, relb, BIG);
    float* TMP3 = (float*)(ws + WS_BIG + 32 * MiB);
    s_gemm<2><<<dim3(D / 64, M / 128), 256, 0, stream>>>(BIG, Wao, D, TMP3, D, 0, 0, 1.f);
    s_resnorm<false><<<M / 4, 256, 0, stream>>>(TMP3, out, out, vec1, V_GM, vec1, V_AF, V_SF, XN);
    s_gemm<1><<<dim3(2 * FF / 64, M / 128), 256, 0, stream>>>(XN, Wgu + (size_t)2 * FF * D, D, BIG, FF, 0, 0, 1.f);
    s_gemm<2><<<dim3(D / 64, M / 128), 256, 0, stream>>>(BIG, Wdn + (size_t)D * FF, FF, TMP2, D, 0, 0, 1.f);
    s_resnorm<true><<<M / 4, 256, 0, stream>>>(TMP2, out, out, vec1, V_GF, nullptr, 0, 0, nullptr);
}
```
